# Optimizing an MI355X kernel written in HIP

```python
import math
import jax, jax.numpy as jnp
from jax import lax
import numpy as np

D_MODEL = 1024
BATCH = 8
SEQ = 2048
DEPTH = 2

GRID_W = 64
CTX_LEN = 256
N_MIXERS = 2
N_HEADS = 8
KV_HEADS = 2
GROUP = N_HEADS // KV_HEADS
HEAD_DIM = D_MODEL // N_HEADS
Q_DIM = N_HEADS * HEAD_DIM
KV_DIM = KV_HEADS * HEAD_DIM
AXIS_DIM = HEAD_DIM // 2
AXIS_PAIRS = AXIS_DIM // 2
ROPE_THETA = 10000.0
Q_BLOCK = 128
ATTN_SCALE = 1.0 / math.sqrt(HEAD_DIM)
POOL_WINDOWS = (2, 4, 8, 16)
POOL_GROUPS = len(POOL_WINDOWS)
POOL_CH = D_MODEL // POOL_GROUPS
D_FF = 2816
CONV_W = 3
N_MOD = 6
EPS = 1e-6

kernel_name = "hybrid_attn_pool_convffn_diffusion_trunk"


def rmsnorm(x, g):
    xf = x.astype(jnp.float32)
    y = xf * lax.rsqrt(jnp.mean(xf * xf, axis=-1, keepdims=True) + EPS)
    return y.astype(x.dtype) * g


def modulate(h, shift, scale):
    return h * (1.0 + scale) + shift


def axial_rope_tables(rows, cols):
    r = jnp.repeat(jnp.arange(rows, dtype=jnp.float32), cols)
    cc = jnp.tile(jnp.arange(cols, dtype=jnp.float32), rows)
    inv = ROPE_THETA ** (-jnp.arange(AXIS_PAIRS, dtype=jnp.float32) / AXIS_PAIRS)
    ang = jnp.stack([r[:, None] * inv, cc[:, None] * inv], axis=1)
    return jnp.cos(ang), jnp.sin(ang)


def apply_axial_rope(x, cos, sin):
    B, L, H, _ = x.shape
    xa = x.reshape(B, L, H, 2, 2, AXIS_PAIRS)
    x1, x2 = xa[..., 0, :], xa[..., 1, :]
    c = cos[None, :, None]
    s = sin[None, :, None]
    out = jnp.stack([x1 * c - x2 * s, x2 * c + x1 * s], axis=-2)
    return out.reshape(B, L, H, HEAD_DIM).astype(x.dtype)


def qkv_proj(h, w_qkv, g_q, g_k):
    B, L, _ = h.shape
    qkv = h @ w_qkv
    q = qkv[..., :Q_DIM].reshape(B, L, N_HEADS, HEAD_DIM)
    k = qkv[..., Q_DIM:Q_DIM + KV_DIM].reshape(B, L, KV_HEADS, HEAD_DIM)
    v = qkv[..., Q_DIM + KV_DIM:].reshape(B, L, KV_HEADS, HEAD_DIM)
    return rmsnorm(q, g_q), rmsnorm(k, g_k), v


def kv_proj(h, w_qkv, g_k):
    B, L, _ = h.shape
    kv = h @ w_qkv[:, Q_DIM:]
    k = kv[..., :KV_DIM].reshape(B, L, KV_HEADS, HEAD_DIM)
    v = kv[..., KV_DIM:].reshape(B, L, KV_HEADS, HEAD_DIM)
    return rmsnorm(k, g_k), v


def gqa_block(qblk, k, v):
    s = jnp.einsum('bqkgd,bskd->bkgqs', qblk, k, preferred_element_type=jnp.float32) * ATTN_SCALE
    p = jax.nn.softmax(s, axis=-1).astype(v.dtype)
    return jnp.einsum('bkgqs,bskd->bqkgd', p, v)


def latent_attention(q, k_all, v_all):
    B, L, _, _ = q.shape
    nblk = L // Q_BLOCK
    qb = q.reshape(B, nblk, Q_BLOCK, KV_HEADS, GROUP, HEAD_DIM).transpose(1, 0, 2, 3, 4, 5)
    o = lax.map(lambda qblk: gqa_block(qblk, k_all, v_all), qb)
    return o.transpose(1, 0, 2, 3, 4, 5).reshape(B, L, Q_DIM)


def context_attention(q, k, v):
    B, L, _, _ = q.shape
    o = gqa_block(q.reshape(B, L, KV_HEADS, GROUP, HEAD_DIM), k, v)
    return o.reshape(B, L, Q_DIM)


def multiscale_pool_mix(h, w_pool, b_pool, pool_scale):
    B, L, _ = h.shape
    hg = h.reshape(B, L, POOL_GROUPS, POOL_CH)
    csum = jnp.concatenate(
        [jnp.zeros((B, 1, POOL_GROUPS, POOL_CH), jnp.float32),
         jnp.cumsum(hg.astype(jnp.float32), axis=1)], axis=1)
    t = jnp.arange(L)
    means = []
    for g, w in enumerate(POOL_WINDOWS):
        lo = jnp.clip(t - w // 2, 0, L)
        hi = jnp.clip(t + (w - w // 2), 0, L)
        cnt = (hi - lo).astype(jnp.float32)
        cg = csum[:, :, g]
        s = jnp.take(cg, hi, axis=1) - jnp.take(cg, lo, axis=1)
        means.append(s / cnt[None, :, None])
    pooled = jnp.stack(means, axis=2).astype(h.dtype) - hg
    y = jnp.einsum('blgc,gce->blge', pooled, w_pool) + b_pool
    return y.reshape(B, L, D_MODEL) * pool_scale


def conv_ffn(h, w_up, conv_w, conv_b, w_down):
    u = h @ w_up
    gate, val = u[..., :D_FF], u[..., D_FF:]
    gp = jnp.pad(gate, ((0, 0), (1, 1), (0, 0)))
    gate = gp[:, :-2] * conv_w[0] + gp[:, 1:-1] * conv_w[1] + gp[:, 2:] * conv_w[2] + conv_b
    return (jax.nn.silu(gate) * val) @ w_down


def setup_inputs(seed: int = 0) -> dict:
    key = jax.random.key(seed)
    ks = jax.random.split(key, 32)
    f32 = jnp.float32
    n_attn = (DEPTH + N_MIXERS - 1) // N_MIXERS
    n_pool = DEPTH // N_MIXERS
    nrm = lambda k, shape, s: jax.random.normal(k, shape, f32) * s
    gain = lambda k, shape: 1.0 + 0.05 * jax.random.normal(k, shape, f32)
    return {
        "x": nrm(ks[0], (BATCH, SEQ, D_MODEL), 1.0),
        "c": nrm(ks[1], (BATCH, D_MODEL), 1.0),
        "ctx": nrm(ks[2], (BATCH, CTX_LEN, D_MODEL), 1.0),
        "c_ctx": nrm(ks[3], (D_MODEL,), 1.0),
        "w_mod": nrm(ks[4], (DEPTH, D_MODEL, N_MOD * D_MODEL), 0.5 * D_MODEL ** -0.5),
        "b_mod": nrm(ks[5], (DEPTH, N_MOD * D_MODEL), 0.02),
        "g_pre_mix": gain(ks[6], (DEPTH, D_MODEL)),
        "g_post_mix": gain(ks[7], (DEPTH, D_MODEL)),
        "g_pre_ffn": gain(ks[8], (DEPTH, D_MODEL)),
        "g_post_ffn": gain(ks[9], (DEPTH, D_MODEL)),
        "w_qkv": nrm(ks[10], (n_attn, D_MODEL, Q_DIM + 2 * KV_DIM), D_MODEL ** -0.5),
        "g_q": gain(ks[11], (n_attn, HEAD_DIM)),
        "g_k": gain(ks[12], (n_attn, HEAD_DIM)),
        "w_o": nrm(ks[13], (n_attn, Q_DIM, D_MODEL), Q_DIM ** -0.5),
        "w_pool": nrm(ks[14], (n_pool, POOL_GROUPS, POOL_CH, POOL_CH), POOL_CH ** -0.5),
        "b_pool": nrm(ks[15], (n_pool, POOL_GROUPS, POOL_CH), 0.02),
        "pool_scale": gain(ks[16], (n_pool, D_MODEL)),
        "w_up": nrm(ks[17], (DEPTH, D_MODEL, 2 * D_FF), D_MODEL ** -0.5),
        "conv_w": nrm(ks[18], (DEPTH, CONV_W, D_FF), CONV_W ** -0.5),
        "conv_b": nrm(ks[19], (DEPTH, D_FF), 0.02),
        "w_down": nrm(ks[20], (DEPTH, D_FF, D_MODEL), D_FF ** -0.5),
    }


def reference(x, c, ctx, c_ctx, w_mod, b_mod, g_pre_mix, g_post_mix, g_pre_ffn, g_post_ffn,
              w_qkv, g_q, g_k, w_o, w_pool, b_pool, pool_scale, w_up, conv_w, conv_b, w_down):
    B, L, _ = x.shape
    ROWS = L // GRID_W
    cos, sin = axial_rope_tables(ROWS, GRID_W)
    sc = jax.nn.silu(c)
    sc_ctx = jax.nn.silu(c_ctx)
    for i in range(DEPTH):
        mixer = i % N_MIXERS
        j = i // N_MIXERS
        update_ctx = any(jj % N_MIXERS == 0 for jj in range(i + 1, DEPTH))
        m = (sc @ w_mod[i] + b_mod[i]).reshape(B, N_MOD, D_MODEL)[:, :, None, :]
        mc = (sc_ctx @ w_mod[i] + b_mod[i]).reshape(N_MOD, D_MODEL)
        shift_m, scale_m, gate_m, shift_f, scale_f, gate_f = [m[:, k] for k in range(N_MOD)]
        cshift_m, cscale_m, cgate_m, cshift_f, cscale_f, cgate_f = [mc[k] for k in range(N_MOD)]

        h = modulate(rmsnorm(x, g_pre_mix[i]), shift_m, scale_m)
        hc = modulate(rmsnorm(ctx, g_pre_mix[i]), cshift_m, cscale_m)
        if mixer == 0:
            q, k, v = qkv_proj(h, w_qkv[j], g_q[j], g_k[j])
            q = apply_axial_rope(q, cos, sin)
            k = apply_axial_rope(k, cos, sin)
            if update_ctx:
                qc, kc, vc = qkv_proj(hc, w_qkv[j], g_q[j], g_k[j])
            else:
                kc, vc = kv_proj(hc, w_qkv[j], g_k[j])
            k_all = jnp.concatenate([kc, k], axis=1)
            v_all = jnp.concatenate([vc, v], axis=1)
            y = latent_attention(q, k_all, v_all) @ w_o[j]
            if update_ctx:
                yc = context_attention(qc, kc, vc) @ w_o[j]
        else:
            y = multiscale_pool_mix(h, w_pool[j], b_pool[j], pool_scale[j])
            if update_ctx:
                yc = multiscale_pool_mix(hc, w_pool[j], b_pool[j], pool_scale[j])
        x = x + gate_m * rmsnorm(y, g_post_mix[i])
        if update_ctx:
            ctx = ctx + cgate_m * rmsnorm(yc, g_post_mix[i])

        h = modulate(rmsnorm(x, g_pre_ffn[i]), shift_f, scale_f)
        x = x + gate_f * rmsnorm(conv_ffn(h, w_up[i], conv_w[i], conv_b[i], w_down[i]), g_post_ffn[i])
        if update_ctx:
            hc = modulate(rmsnorm(ctx, g_pre_ffn[i]), cshift_f, cscale_f)
            ctx = ctx + cgate_f * rmsnorm(conv_ffn(hc, w_up[i], conv_w[i], conv_b[i], w_down[i]), g_post_ffn[i])
    return x
```

```cpp
#include <hip/hip_runtime.h>
#include <hip/hip_bf16.h>
#include <cstdio>
#include <cstdint>

#ifndef MK_N_LAUNCHES
#define MK_N_LAUNCHES 15
#endif

namespace pg8 {
#define PG8_LAS __attribute__((address_space(3)))
typedef unsigned short bf16_t;
typedef short bf16x8 __attribute__((ext_vector_type(8)));
typedef float f32x4 __attribute__((ext_vector_type(4)));
typedef unsigned u32x4 __attribute__((ext_vector_type(4)));
constexpr int BM = 256, BK = 64, HALF = 128, HTB = HALF * BK * 2, STAGE_BYTES = 8 * HTB, NXCD = 8, WGM = 8;

__host__ __device__ __forceinline__ int lds_byte(int r, int c) { const int st = (r >> 4) * 2 + (c >> 5), rr = r & 15, cc = c & 31, ob = rr * 64 + cc * 2; return st * 1024 + (ob ^ (((ob >> 9) & 1) << 5)); }
__host__ __device__ __forceinline__ void stage_rc(int b, int& R, int& C) { const int st = b / 1024, sb = b % 1024, swz = sb ^ (((sb >> 9) & 1) << 5); R = (st >> 1) * 16 + swz / 64; C = (st & 1) * 32 + (swz % 64) / 2; }
__host__ __device__ __forceinline__ int perm32(int rho) { const int n = rho >> 4, i = rho & 15; return 8 * (i >> 2) + 4 * n + (i & 3); }

struct Unit { int pm, pn; };
struct Gemm { const bf16_t* A; const bf16_t* Bt; int K, lda, a_rows, a_row0, a_pn_bytes; };

struct StaticOrder {
    int nM, nN, nwg, G, c;
    __host__ __device__ void init(int nM_, int nN_, int G_, int c_) { nM = nM_; nN = nN_; nwg = nM * nN; G = G_; c = c_; }
    __host__ __device__ bool next(int i, Unit& u) const {
        const long L = (long)i * G + c; if (L >= nwg) return false;
        int wgid = (int)L; { const int q = nwg / NXCD, r = nwg % NXCD, xcd = wgid % NXCD, off = wgid / NXCD; wgid = (xcd < r ? xcd * (q + 1) : r * (q + 1) + (xcd - r) * q) + off; }
        const int nig = WGM * nN, gid = wgid / nig, fm = gid * WGM, gsz = (nM - fm) < WGM ? (nM - fm) : WGM;
        u.pm = fm + ((wgid % nig) % gsz); u.pn = (wgid % nig) / gsz; return true;
    }
};

__device__ __forceinline__ unsigned cvt_pk_bf16(float lo, float hi) { unsigned r; asm volatile("v_cvt_pk_bf16_f32 %0, %1, %2" : "=v"(r) : "v"(lo), "v"(hi)); return r; }

struct EpiF32 {
    static constexpr bool PERM = false;
    float* C; int ldc; const float* bias; const float* cscale;
    __device__ __forceinline__ void operator()(const f32x4 (&acc)[2][2][4][2], const Unit& u, int wr, int wc, int fr, int fq) const {
        const int row0 = u.pm * BM + wr * 64 + fr, col0 = u.pn * BM + wc * 32 + 4 * fq;
#pragma unroll
        for (int bj = 0; bj < 2; ++bj)
#pragma unroll
            for (int n = 0; n < 2; ++n) {
                const f32x4 bv = bias ? *(const f32x4*)(bias + col0 + bj * HALF + n * 16) : (f32x4){0.f, 0.f, 0.f, 0.f};
                const f32x4 sv = cscale ? *(const f32x4*)(cscale + col0 + bj * HALF + n * 16) : (f32x4){1.f, 1.f, 1.f, 1.f};
#pragma unroll
                for (int ai = 0; ai < 2; ++ai)
#pragma unroll
                    for (int m = 0; m < 4; ++m) *(f32x4*)(C + (size_t)(row0 + ai * HALF + m * 16) * ldc + col0 + bj * HALF + n * 16) = (acc[ai][bj][m][n] + bv) * sv;
            }
    }
};

struct EpiQKV {
    static constexpr bool PERM = true;
    bf16_t *Q, *Kb, *Vb; const float *gq, *gk, *cosT, *sinT; PG8_LAS float* xl;
    __device__ __forceinline__ void operator()(const f32x4 (&acc)[2][2][4][2], const Unit& u, int wr, int wc, int fr, int fq) const {
        const bool ctx = u.pm >= 64; const int pn = u.pn;
        if (ctx && pn < 4) return;
        if (pn == 5) {
#pragma unroll
            for (int ai = 0; ai < 2; ++ai)
#pragma unroll
                for (int m = 0; m < 4; ++m) { const int row = ai * HALF + wr * 64 + m * 16 + fr; int b, key;
                    if (ctx) { b = u.pm - 64; key = row; } else { const int R = u.pm * BM + row; b = R >> 11; key = 256 + (R & 2047); }
#pragma unroll
                    for (int bj = 0; bj < 2; ++bj) { const f32x4 v0 = acc[ai][bj][m][0], v1 = acc[ai][bj][m][1]; u32x4 w;
                        w.x = cvt_pk_bf16(v0[0], v0[1]); w.y = cvt_pk_bf16(v0[2], v0[3]); w.z = cvt_pk_bf16(v1[0], v1[1]); w.w = cvt_pk_bf16(v1[2], v1[3]);
                        *(u32x4*)(Vb + ((size_t)(b * 2 + bj) * 2304 + key) * 128 + wc * 32 + 8 * fq) = w; } }
            return;
        }
#pragma unroll
        for (int ai = 0; ai < 2; ++ai)
#pragma unroll
            for (int m = 0; m < 4; ++m)
#pragma unroll
                for (int bj = 0; bj < 2; ++bj) { const f32x4 a = acc[ai][bj][m][0], b = acc[ai][bj][m][1];
                    float s = (a[0] * a[0] + a[1] * a[1]) + (a[2] * a[2] + a[3] * a[3]) + (b[0] * b[0] + b[1] * b[1]) + (b[2] * b[2] + b[3] * b[3]);
                    s += __shfl_xor(s, 16); s += __shfl_xor(s, 32);
                    if (fq == 0) xl[((ai * HALF + wr * 64 + m * 16 + fr) * 2 + bj) * 4 + wc] = s; }
        asm volatile("s_waitcnt lgkmcnt(0)" ::: "memory"); __builtin_amdgcn_s_barrier(); asm volatile("" ::: "memory");
        const float* g = (pn == 4) ? gk : gq;
        const int gbase = 64 * (wc >> 1) + 16 * (wc & 1) + 4 * fq;
        const f32x4 g0 = *(const f32x4*)(g + gbase), g1 = *(const f32x4*)(g + gbase + 32);
        const bool rope = !ctx; const int p0 = 16 * (wc & 1) + 4 * fq;
#pragma unroll
        for (int ai = 0; ai < 2; ++ai)
#pragma unroll
            for (int m = 0; m < 4; ++m) { const int row = ai * HALF + wr * 64 + m * 16 + fr; int b, l;
                if (ctx) { b = u.pm - 64; l = row; } else { const int R = u.pm * BM + row; b = R >> 11; l = R & 2047; }
                f32x4 cs = {1.f, 1.f, 1.f, 1.f}, sn = {0.f, 0.f, 0.f, 0.f};
                if (rope) { const int pos = (wc >> 1) ? (l & 63) : (l >> 6); cs = *(const f32x4*)(cosT + pos * 32 + p0); sn = *(const f32x4*)(sinT + pos * 32 + p0); }
#pragma unroll
                for (int bj = 0; bj < 2; ++bj) { const f32x4 ps = *(const PG8_LAS f32x4*)(xl + (row * 2 + bj) * 4);
                    const float rstd = 1.0f / sqrtf(((ps[0] + ps[1]) + (ps[2] + ps[3])) * (1.0f / 128.0f) + 1e-6f);
                    const f32x4 x1 = acc[ai][bj][m][0] * rstd * g0, x2 = acc[ai][bj][m][1] * rstd * g1;
                    const f32x4 o1 = x1 * cs - x2 * sn, o2 = x2 * cs + x1 * sn; u32x4 w;
                    w.x = cvt_pk_bf16(o1[0], o1[1]); w.y = cvt_pk_bf16(o1[2], o1[3]); w.z = cvt_pk_bf16(o2[0], o2[1]); w.w = cvt_pk_bf16(o2[2], o2[3]);
                    bf16_t* dst;
                    if (pn == 4) dst = Kb + ((size_t)(b * 2 + bj) * 2304 + (ctx ? l : 256 + l)) * 128;
                    else dst = Q + ((size_t)(b * 8 + pn * 2 + bj) * 2048 + l) * 128;
                    *(u32x4*)(dst + wc * 32 + 8 * fq) = w; }
                if (m & 1) asm volatile("" ::: "memory"); }
    }
};

struct EpiGate {
    static constexpr bool PERM = true;
    bf16_t* ACT; const float* cw; const float* cb; PG8_LAS float* hl;
    __device__ __forceinline__ void operator()(const f32x4 (&acc)[2][2][4][2], const Unit& u, int wr, int wc, int fr, int fq) const {
        const int cg = wc * 32 + 8 * fq, lane = fq * 16 + fr;
#pragma unroll
        for (int ai = 0; ai < 2; ++ai) { const int blk = 2 * ai + wr;
            if (fr == 0)  { *(PG8_LAS f32x4*)(hl + blk * 128 + cg) = acc[ai][0][0][0]; *(PG8_LAS f32x4*)(hl + blk * 128 + cg + 4) = acc[ai][0][0][1]; }
            if (fr == 15) { *(PG8_LAS f32x4*)(hl + 512 + blk * 128 + cg) = acc[ai][0][3][0]; *(PG8_LAS f32x4*)(hl + 512 + blk * 128 + cg + 4) = acc[ai][0][3][1]; } }
        asm volatile("s_waitcnt lgkmcnt(0)" ::: "memory"); __builtin_amdgcn_s_barrier(); asm volatile("" ::: "memory");
        const int gcol = u.pn * 128 + cg;
        const int tbase = 254 * u.pm - 1, rz = (-tbase) & 2047, lim = 16384 - tbase;
        const int src_prev = (lane & 48) | ((fr + 15) & 15), src_next = (lane & 48) | ((fr + 1) & 15);
        typedef unsigned u32x2 __attribute__((ext_vector_type(2)));
#pragma unroll
        for (int n = 0; n < 2; ++n) {
            const f32x4 w0 = *(const f32x4*)(cw + gcol + 4 * n), w1 = *(const f32x4*)(cw + 2816 + gcol + 4 * n), w2 = *(const f32x4*)(cw + 5632 + gcol + 4 * n), bb = *(const f32x4*)(cb + gcol + 4 * n);
#pragma unroll
            for (int ai = 0; ai < 2; ++ai) { const int blk = 2 * ai + wr;
                f32x4 hp = {0.f, 0.f, 0.f, 0.f}, hn = {0.f, 0.f, 0.f, 0.f};
                if (blk > 0) hp = *(const PG8_LAS f32x4*)(hl + 512 + (blk - 1) * 128 + cg + 4 * n);
                if (blk < 3) hn = *(const PG8_LAS f32x4*)(hl + (blk + 1) * 128 + cg + 4 * n);
#pragma unroll
                for (int m = 0; m < 4; ++m) {
                    const f32x4 gcur = acc[ai][0][m][n];
                    const f32x4 gpm = (m > 0) ? acc[ai][0][m - 1][n] : hp;
                    const f32x4 gnm = (m < 3) ? acc[ai][0][m + 1][n] : hn;
                    const int r = ai * HALF + wr * 64 + m * 16 + fr;
                    f32x4 pv, nv;
#pragma unroll
                    for (int j = 0; j < 4; ++j) { const float tp = (fr == 15) ? gpm[j] : gcur[j], tn = (fr == 0) ? gnm[j] : gcur[j];
                        pv[j] = __shfl(tp, src_prev); nv[j] = __shfl(tn, src_next); }
                    if (r == rz) pv = (f32x4){0.f, 0.f, 0.f, 0.f};
                    if (r == rz - 1) nv = (f32x4){0.f, 0.f, 0.f, 0.f};
                    const f32x4 gg = w0 * pv + w1 * gcur + w2 * nv + bb; const f32x4 vv = acc[ai][1][m][n]; f32x4 o;
#pragma unroll
                    for (int j = 0; j < 4; ++j) { const float e = __builtin_amdgcn_exp2f(gg[j] * -1.4426950408889634f); o[j] = gg[j] * __builtin_amdgcn_rcpf(1.0f + e) * vv[j]; }
                    bool ok = r < lim;
                    if (ai == 0 && m == 0) ok = ok && ((wr | fr) != 0);
                    if (ai == 1 && m == 3) ok = ok && !(wr == 1 && fr == 15);
                    if (ok) { const int t = tbase + r; u32x2 w; w.x = cvt_pk_bf16(o[0], o[1]); w.y = cvt_pk_bf16(o[2], o[3]);
                        *(u32x2*)(ACT + (size_t)t * 2816 + gcol + 4 * n) = w; }
                }
            }
        }
    }
};

template <class Epi, class Sched>
__device__ __forceinline__ void gemm_phase(PG8_LAS unsigned char* lds, const Gemm g, const Sched& S, const Epi& E) {
    const int tid = threadIdx.x, wid = __builtin_amdgcn_readfirstlane(tid >> 6), lane = tid & 63, wr = wid >> 2, wc = wid & 3, fr = lane & 15, fq = lane >> 4;
    const int K = g.K, nt = K / BK;
    unsigned voffA[2], voffB[2];
#pragma unroll
    for (int i = 0; i < 2; ++i) { int R, C; stage_rc(tid * 16 + i * 8192, R, C); const int Rb = Epi::PERM ? ((R & ~31) + perm32(R & 31)) : R;
        voffA[i] = (unsigned)(R * g.lda + C) * 2u; voffB[i] = (unsigned)(Rb * K + C) * 2u; }
    const size_t kstep = (size_t)(BK * 2);
    const size_t hstepA = (size_t)HALF * g.lda * 2, hstepB = (size_t)HALF * K * 2, tstepB = 2 * hstepB;
    const unsigned ldsw = (unsigned)wid * 1024u;
    const int aoff = lds_byte(wr * 64 + fr, fq * 8), boff = lds_byte(wc * 32 + fr, fq * 8);
#define PG8_APTR(u) ((const char*)g.A + ((long)(u).pm * g.a_rows + g.a_row0) * (long)g.lda * 2 + (long)(u).pn * g.a_pn_bytes)
#define PG8_BPTR(u) ((const char*)g.Bt + (size_t)(u).pn * tstepB)
#define PG8_SA(b, h) (((b) * 2 + (h)) * HTB)
#define PG8_SB(b, h) ((4 + (b) * 2 + (h)) * HTB)
#define PG8_STAGE(bufoff, gbase, voff) do { _Pragma("unroll") for (int _i = 0; _i < 2; ++_i) \
        __builtin_amdgcn_global_load_lds((const unsigned*)((const char*)(gbase) + (voff)[_i]), (PG8_LAS unsigned*)(lds + (bufoff) + ldsw + _i * 8192), 16, 0, 0); } while (0)
#define PG8_LDA(dst, b, h) do { _Pragma("unroll") for (int m = 0; m < 4; ++m) _Pragma("unroll") for (int k = 0; k < 2; ++k) dst[m][k] = *(const PG8_LAS bf16x8*)(lds + PG8_SA(b, h) + aoff + m * 2048 + k * 1024); } while (0)
#define PG8_LDB(dst, b, h) do { _Pragma("unroll") for (int n = 0; n < 2; ++n) _Pragma("unroll") for (int k = 0; k < 2; ++k) dst[n][k] = *(const PG8_LAS bf16x8*)(lds + PG8_SB(b, h) + boff + n * 2048 + k * 1024); } while (0)
#define PG8_MMA(ai, bj, At, Bt) do { __builtin_amdgcn_s_setprio(1); _Pragma("unroll") for (int m = 0; m < 4; ++m) _Pragma("unroll") for (int n = 0; n < 2; ++n) _Pragma("unroll") for (int k = 0; k < 2; ++k) \
        acc[ai][bj][m][n] = __builtin_amdgcn_mfma_f32_16x16x32_bf16(Bt[n][k], At[m][k], acc[ai][bj][m][n], 0, 0, 0); __builtin_amdgcn_s_setprio(0); } while (0)
#define PG8_WAIT_V(n) asm volatile("s_waitcnt vmcnt(" #n ")" ::: "memory")
#define PG8_WAIT_L(n) asm volatile("s_waitcnt lgkmcnt(" #n ")" ::: "memory")
#define PG8_BAR __builtin_amdgcn_s_barrier()
#define PG8_SCHED __builtin_amdgcn_sched_barrier(0)
    Unit cur, nxt; int ui = 0;
    if (!S.next(0, cur)) return;
    f32x4 acc[2][2][4][2];
#pragma unroll
    for (int a = 0; a < 2; ++a)
#pragma unroll
        for (int b = 0; b < 2; ++b)
#pragma unroll
            for (int m = 0; m < 4; ++m)
#pragma unroll
                for (int n = 0; n < 2; ++n) acc[a][b][m][n] = (f32x4){0.f, 0.f, 0.f, 0.f};
    bf16x8 At[4][2], B0[2][2], B1[2][2];
    const char* cA = PG8_APTR(cur); const char* cB = PG8_BPTR(cur);
    PG8_STAGE(PG8_SB(0, 0), cB, voffB); PG8_STAGE(PG8_SB(0, 1), cB + hstepB, voffB); PG8_STAGE(PG8_SA(0, 0), cA, voffA); PG8_STAGE(PG8_SA(0, 1), cA + hstepA, voffA);
    if (wr == 1) PG8_BAR;
    PG8_WAIT_V(2); PG8_BAR;
    PG8_STAGE(PG8_SB(1, 0), cB + kstep, voffB); PG8_STAGE(PG8_SA(1, 0), cA + kstep, voffA); PG8_STAGE(PG8_SB(1, 1), cB + hstepB + kstep, voffB);
    PG8_WAIT_V(6); PG8_BAR;
    for (;;) {
        const bool has_next = S.next(ui + 1, nxt);
        const char* nA = has_next ? PG8_APTR(nxt) : cA; const char* nB = has_next ? PG8_BPTR(nxt) : cB;
        for (int t = 0; t < nt; t += 2) {
            const bool last = (t == nt - 2);
            const char* a1 = cA + (size_t)(t + 1) * kstep;
            const char* a2 = last ? nA : cA + (size_t)(t + 2) * kstep; const char* b2 = last ? nB : cB + (size_t)(t + 2) * kstep;
            const char* a3 = a2 + kstep; const char* b3 = b2 + kstep;
            PG8_LDB(B0, 0, 0); PG8_LDB(B1, 0, 1); PG8_SCHED; PG8_LDA(At, 0, 0); PG8_STAGE(PG8_SA(1, 1), a1 + hstepA, voffA);
            PG8_WAIT_V(8); PG8_WAIT_L(0); PG8_BAR; PG8_MMA(0, 0, At, B0); PG8_MMA(0, 1, At, B1); PG8_BAR; PG8_SCHED;
            PG8_LDA(At, 0, 1); PG8_STAGE(PG8_SB(0, 0), b2, voffB); PG8_STAGE(PG8_SB(0, 1), b2 + hstepB, voffB); PG8_STAGE(PG8_SA(0, 0), a2, voffA);
            PG8_WAIT_V(8); PG8_WAIT_L(0); PG8_BAR; PG8_MMA(1, 0, At, B0); PG8_MMA(1, 1, At, B1); PG8_BAR; PG8_SCHED;
            PG8_LDB(B0, 1, 0); PG8_LDB(B1, 1, 1); PG8_SCHED; PG8_LDA(At, 1, 0); PG8_STAGE(PG8_SA(0, 1), a2 + hstepA, voffA);
            PG8_WAIT_V(8); PG8_WAIT_L(0); PG8_BAR; PG8_MMA(0, 0, At, B0); PG8_MMA(0, 1, At, B1); PG8_BAR; PG8_SCHED;
            PG8_LDA(At, 1, 1); PG8_STAGE(PG8_SB(1, 0), b3, voffB); PG8_STAGE(PG8_SB(1, 1), b3 + hstepB, voffB); PG8_STAGE(PG8_SA(1, 0), a3, voffA);
            PG8_WAIT_V(8); PG8_WAIT_L(0); PG8_BAR; PG8_MMA(1, 0, At, B0); PG8_MMA(1, 1, At, B1); PG8_BAR; PG8_SCHED;
        }
        if (wr == 0) PG8_BAR;
        E(acc, cur, wr, wc, fr, fq);
        if (!has_next) break;
#pragma unroll
        for (int a = 0; a < 2; ++a)
#pragma unroll
            for (int b = 0; b < 2; ++b)
#pragma unroll
                for (int m = 0; m < 4; ++m)
#pragma unroll
                    for (int n = 0; n < 2; ++n) acc[a][b][m][n] = (f32x4){0.f, 0.f, 0.f, 0.f};
        cur = nxt; cA = nA; cB = nB; ++ui;
        if (wr == 1) PG8_BAR;
    }
    PG8_WAIT_V(0);
    PG8_BAR;
#undef PG8_APTR
#undef PG8_BPTR
#undef PG8_SA
#undef PG8_SB
#undef PG8_STAGE
#undef PG8_LDA
#undef PG8_LDB
#undef PG8_MMA
#undef PG8_WAIT_V
#undef PG8_WAIT_L
#undef PG8_BAR
#undef PG8_SCHED
}
}

namespace att {
using bf16 = __hip_bfloat16;
constexpr int D = 128, NW = 8, QBLK = 32, KVBLK = 64;
constexpr float SCALE = 0.088388347648318440f;
constexpr float THR = 8.f;
constexpr int LDQ = 128, LDK = 128, LDO = 1024;
constexpr size_t SHM_V = KVBLK * D * 2, SHM_K = KVBLK * D * 2, SHM_ATTN = 2 * SHM_V + 2 * SHM_K + NW * 64 * 4;
using bf16x8 = __attribute__((ext_vector_type(8))) short;
using s16x4  = __attribute__((ext_vector_type(4))) short;
using f32x16 = __attribute__((ext_vector_type(16))) float;
using u32x4  = __attribute__((ext_vector_type(4))) unsigned;
#define KSWZ(row, colB) ((row) * 256 + ((colB) ^ (((row) & 7) << 4)))
#define SBAR() __builtin_amdgcn_sched_barrier(0)
__device__ __forceinline__ int crow(int r, int hi) { return (r & 3) + 8 * (r >> 2) + 4 * hi; }
__device__ __forceinline__ unsigned cvtpk(float lo, float hi) { unsigned r; asm volatile("v_cvt_pk_bf16_f32 %0, %1, %2" : "=v"(r) : "v"(lo), "v"(hi)); return r; }
__device__ __forceinline__ bf16x8 ld8(const bf16* p) { return *reinterpret_cast<const bf16x8*>(p); }

__device__ __forceinline__ void partialSM(f32x16& p0, f32x16& p1, float& m_reg, float& mn, float& alpha) {
  constexpr float C = SCALE * 1.4426950408889634f;
  float pmax = p0[0]; for (int r = 1; r < 16; ++r) pmax = fmaxf(pmax, p0[r]); for (int r = 0; r < 16; ++r) pmax = fmaxf(pmax, p1[r]);
  { auto rr = __builtin_amdgcn_permlane32_swap(__float_as_uint(pmax), __float_as_uint(pmax), false, false);
    pmax = fmaxf(__uint_as_float(rr[0]), __uint_as_float(rr[1])); }
  if (__builtin_expect(__all(pmax - m_reg <= THR / SCALE), 1)) { mn = m_reg; alpha = 1.f; }
  else { mn = fmaxf(m_reg, pmax); alpha = __builtin_amdgcn_exp2f((m_reg - mn) * C); m_reg = mn; }
  float mnC = -mn * C;
  for (int r = 0; r < 16; ++r) p0[r] = fmaf(p0[r], C, mnC); for (int r = 0; r < 16; ++r) p1[r] = fmaf(p1[r], C, mnC);
  for (int r = 0; r < 16; ++r) p0[r] = __builtin_amdgcn_exp2f(p0[r]);
}
__device__ __forceinline__ void finishSM(f32x16& p0, f32x16& p1, float alpha, float& l_reg, bf16x8& pa0, bf16x8& pa1, bf16x8& pa2, bf16x8& pa3) {
  for (int r = 0; r < 16; ++r) p1[r] = __builtin_amdgcn_exp2f(p1[r]);
  float ps = 0; for (int r = 0; r < 16; ++r) ps += p0[r]; for (int r = 0; r < 16; ++r) ps += p1[r];
  { auto rr = __builtin_amdgcn_permlane32_swap(__float_as_uint(ps), __float_as_uint(ps), false, false);
    ps = __uint_as_float(rr[0]) + __uint_as_float(rr[1]); }
  l_reg = l_reg * alpha + ps;
#define PK4(P, BASE, OUT) do { unsigned a0 = cvtpk(P[BASE + 0], P[BASE + 1]), a1 = cvtpk(P[BASE + 2], P[BASE + 3]);   \
    unsigned b0 = cvtpk(P[BASE + 4], P[BASE + 5]), b1 = cvtpk(P[BASE + 6], P[BASE + 7]);                              \
    auto r0 = __builtin_amdgcn_permlane32_swap(a0, b0, false, false); auto r1 = __builtin_amdgcn_permlane32_swap(a1, b1, false, false); \
    u32x4 w = {r0[0], r1[0], r0[1], r1[1]}; OUT = *reinterpret_cast<bf16x8*>(&w); } while (0)
  PK4(p0, 0, pa0); PK4(p0, 8, pa1); PK4(p1, 0, pa2); PK4(p1, 8, pa3);
#undef PK4
}
__device__ __forceinline__ void qkt(f32x16& p0, f32x16& p1, const bf16* Ks, const bf16x8* qr, int r32, int hi) {
  p0 = f32x16{}; p1 = f32x16{};
  for (int d0 = 0; d0 < 8; ++d0) { int cb = (d0 * 16 + hi * 8) * 2;
    bf16x8 b0 = *reinterpret_cast<const bf16x8*>((const char*)Ks + KSWZ(r32, cb));
    bf16x8 b1 = *reinterpret_cast<const bf16x8*>((const char*)Ks + KSWZ(32 + r32, cb));
    p0 = __builtin_amdgcn_mfma_f32_32x32x16_bf16(b0, qr[d0], p0, 0, 0, 0);
    p1 = __builtin_amdgcn_mfma_f32_32x32x16_bf16(b1, qr[d0], p1, 0, 0, 0); }
}
__device__ __forceinline__ int v_st(int k, int c) { const int kk = (k & ~0xC) | ((k & 4) << 1) | ((k & 8) >> 1); return ((kk >> 3) * 4 + (c >> 5)) * 512 + ((kk & 7) * 32 + (c & 31)) * 2; }
__device__ __forceinline__ int v_rd_base(int lane) { return ((lane & 3) << 3) | (((lane >> 2) & 3) << 6) | (((lane >> 4) & 1) << 5) | (((lane >> 5) & 1) << 8); }
constexpr int v_rd_off(int d0, int ks, int half) { return d0 * 512 + ks * 4096 + half * 2048; }
template <int OFF> __device__ __forceinline__ s16x4 tr_read(int vb) {
  s16x4 r; asm volatile("ds_read_b64_tr_b16 %0, %1 offset:%2" : "=&v"(r) : "v"(vb), "i"(OFF) : "memory"); return r;
}
template <int D0> __device__ __forceinline__ void pv_one(f32x16& od, int vb, bf16x8 pa0, bf16x8 pa1, bf16x8 pa2, bf16x8 pa3) {
  const s16x4 l0 = tr_read<v_rd_off(D0, 0, 0)>(vb), h0 = tr_read<v_rd_off(D0, 0, 1)>(vb), l1 = tr_read<v_rd_off(D0, 1, 0)>(vb), h1 = tr_read<v_rd_off(D0, 1, 1)>(vb);
  const s16x4 l2 = tr_read<v_rd_off(D0, 2, 0)>(vb), h2 = tr_read<v_rd_off(D0, 2, 1)>(vb), l3 = tr_read<v_rd_off(D0, 3, 0)>(vb), h3 = tr_read<v_rd_off(D0, 3, 1)>(vb);
  asm volatile("s_waitcnt lgkmcnt(0)" ::: "memory"); SBAR();
#define PK(L, H) (bf16x8){L[0], L[1], L[2], L[3], H[0], H[1], H[2], H[3]}
  od = __builtin_amdgcn_mfma_f32_32x32x16_bf16(pa0, PK(l0, h0), od, 0, 0, 0);
  od = __builtin_amdgcn_mfma_f32_32x32x16_bf16(pa1, PK(l1, h1), od, 0, 0, 0);
  od = __builtin_amdgcn_mfma_f32_32x32x16_bf16(pa2, PK(l2, h2), od, 0, 0, 0);
  od = __builtin_amdgcn_mfma_f32_32x32x16_bf16(pa3, PK(l3, h3), od, 0, 0, 0);
#undef PK
}
__device__ __forceinline__ void pv_d0(f32x16* o, int vb, bf16x8 pa0, bf16x8 pa1, bf16x8 pa2, bf16x8 pa3) {
  pv_one<0>(o[0], vb, pa0, pa1, pa2, pa3); pv_one<1>(o[1], vb, pa0, pa1, pa2, pa3); pv_one<2>(o[2], vb, pa0, pa1, pa2, pa3); pv_one<3>(o[3], vb, pa0, pa1, pa2, pa3);
}

__device__ __forceinline__ void attn_dense_body(const bf16* __restrict__ Qb, const bf16* __restrict__ Kh, const bf16* __restrict__ Vh,
                                                unsigned short* __restrict__ Ob, int seq, char* lds) {
  const int tid = threadIdx.x, wid = tid >> 6, lane = tid & 63, r32 = lane & 31, hi = lane >> 5;
  bf16* V_lds = (bf16*)lds; bf16* K_lds = (bf16*)(lds + 2 * SHM_V);
  float* ws = (float*)(lds + 2 * SHM_V + 2 * SHM_K) + wid * 64; float* li_l = ws; float* al_l = ws + 32;
  float m_reg = -1e30f, l_reg = 0; f32x16 o[4] = {}; bf16x8 qr[8];
  const bf16* Qw = Qb + (long)(wid * QBLK + r32) * LDQ + hi * 8;
#pragma unroll
  for (int d0 = 0; d0 < 8; ++d0) qr[d0] = ld8(Qw + d0 * 16);
  const int sr = tid >> 4, sc = (tid & 15) * 8, vst0 = v_st(sr, sc), vst1 = v_st(32 + sr, sc);
  const int vb0 = (int)(uintptr_t)V_lds + v_rd_base(lane);
  struct { bf16x8 vs0, vs1, ks0, ks1; } sr_[2];
#define SLOAD(i, k0) do { sr_[i].vs0 = ld8(&Vh[(long)((k0) + sr) * LDK + sc]); sr_[i].vs1 = ld8(&Vh[(long)((k0) + 32 + sr) * LDK + sc]); \
    sr_[i].ks0 = ld8(&Kh[(long)((k0) + sr) * LDK + sc]); sr_[i].ks1 = ld8(&Kh[(long)((k0) + 32 + sr) * LDK + sc]); } while (0)
#define SWRITE(b, i) do { *(bf16x8*)((char*)V_lds + (b) * SHM_V + vst0) = sr_[i].vs0;          \
    *(bf16x8*)((char*)V_lds + (b) * SHM_V + vst1) = sr_[i].vs1; int kc = sc * 2;               \
    *(bf16x8*)((char*)K_lds + (b) * SHM_K + KSWZ(sr, kc)) = sr_[i].ks0;                       \
    *(bf16x8*)((char*)K_lds + (b) * SHM_K + KSWZ(32 + sr, kc)) = sr_[i].ks1; } while (0)
#define SWAIT() asm volatile("s_waitcnt vmcnt(4)" ::: "memory")
#define RESC(a) do { if (__any((a) < 1.f)) { if (hi == 0) al_l[r32] = (a); asm volatile("s_waitcnt lgkmcnt(0)" ::: "memory"); \
    for (int d = 0; d < 4; ++d) for (int r = 0; r < 16; ++r) o[d][r] *= al_l[crow(r, hi)]; } } while (0)
  f32x16 pA0, pA1, pB0, pB1; float mnA, mnB, alA, alB; bf16x8 pa0, pa1, pa2, pa3; const int NT = seq / KVBLK;
  constexpr int SE = 0, SO = 1;
  SLOAD(SE, 0); asm volatile("s_waitcnt vmcnt(0)" ::: "memory"); SWRITE(0, SE); __syncthreads();
  qkt(pA0, pA1, K_lds, qr, r32, hi); partialSM(pA0, pA1, m_reg, mnA, alA);
  SLOAD(SO, KVBLK); if (2 < NT) SLOAD(SE, 2 * KVBLK);
  SWAIT(); SWRITE(1, SO); __syncthreads();
  for (int j = 1; j + 1 < NT; j += 2) {
    SBAR(); qkt(pB0, pB1, (bf16*)((char*)K_lds + SHM_K), qr, r32, hi);
    finishSM(pA0, pA1, alA, l_reg, pa0, pa1, pa2, pa3); SBAR();
    SLOAD(SO, (j + 2) * KVBLK); SBAR();
    pv_d0(o, vb0, pa0, pa1, pa2, pa3); partialSM(pB0, pB1, m_reg, mnB, alB);
    __syncthreads(); SWAIT(); SWRITE(0, SE);
    RESC(alB); __syncthreads();
    SBAR(); qkt(pA0, pA1, K_lds, qr, r32, hi);
    finishSM(pB0, pB1, alB, l_reg, pa0, pa1, pa2, pa3); SBAR();
    if (j + 3 < NT) SLOAD(SE, (j + 3) * KVBLK); SBAR();
    pv_d0(o, vb0 + (int)SHM_V, pa0, pa1, pa2, pa3); partialSM(pA0, pA1, m_reg, mnA, alA);
    __syncthreads(); SWAIT(); SWRITE(1, SO);
    RESC(alA); __syncthreads();
  }
  SBAR(); qkt(pB0, pB1, (bf16*)((char*)K_lds + SHM_K), qr, r32, hi);
  finishSM(pA0, pA1, alA, l_reg, pa0, pa1, pa2, pa3); SBAR();
  pv_d0(o, vb0, pa0, pa1, pa2, pa3); partialSM(pB0, pB1, m_reg, mnB, alB);
  __syncthreads(); RESC(alB);
  finishSM(pB0, pB1, alB, l_reg, pa0, pa1, pa2, pa3); SBAR();
  pv_d0(o, vb0 + (int)SHM_V, pa0, pa1, pa2, pa3);
  if (hi == 0) li_l[r32] = l_reg; asm volatile("s_waitcnt lgkmcnt(0)" ::: "memory");
  float rli[16];
#pragma unroll
  for (int r = 0; r < 16; ++r) rli[r] = __builtin_amdgcn_rcpf(li_l[crow(r, hi)]);
  unsigned short* Ow = Ob + (long)(wid * QBLK) * LDO;
#pragma unroll
  for (int r = 0; r < 16; ++r) { int orow = crow(r, hi);
#pragma unroll
    for (int d0 = 0; d0 < 4; ++d0) { const float v = o[d0][r] * rli[r]; Ow[(long)orow * LDO + d0 * 32 + r32] = (unsigned short)(cvtpk(v, v) & 0xffffu); } }
  __syncthreads();
#undef SLOAD
#undef SWRITE
#undef SWAIT
#undef RESC
}
}

constexpr int NWAVES = 8;
constexpr int N_LAUNCHES = MK_N_LAUNCHES;
constexpr int N_PHASES = 15;
static_assert(N_LAUNCHES == 1 || N_LAUNCHES == N_PHASES, "MK_N_LAUNCHES is 1 or 15");

constexpr int BATCH = 8, SEQ = 2048, DM = 1024, MLAT = BATCH * SEQ, CTXL = 256, MCTX = BATCH * CTXL, MTOT = MLAT + MCTX;
constexpr int NQKV = 1536, SKV = CTXL + SEQ, DFF = 2816, NUP = 2 * DFF, NMOD = 6 * DM;
constexpr float EPS = 1e-6f;

constexpr size_t MiB = 1u << 20;
constexpr size_t WS_CTL = 0, CTL_ZERO_BYTES = 1 * MiB;
constexpr size_t WS_MOD = 1 * MiB;
constexpr size_t WS_COS = 1 * MiB + 512 * 1024, WS_SIN = WS_COS + 8192;
constexpr size_t WS_WQKV = 2 * MiB, WS_WO = 5 * MiB, WS_WUP0 = 7 * MiB, WS_WUP1 = 18 * MiB, WS_WDN0 = 29 * MiB, WS_WDN1 = 29 * MiB + 5632 * 1024, WS_WPOOL = 40 * MiB;
constexpr size_t WS_XN = 44 * MiB;
constexpr size_t WS_Q = 80 * MiB, WS_K = 112 * MiB, WS_V = 122 * MiB, WS_O = 132 * MiB;
constexpr size_t WS_ACT = 44 * MiB;
constexpr size_t WS_XN2 = 132 * MiB + 2048;
constexpr size_t WS_Y = 165 * MiB;
constexpr size_t WS_H1 = 44 * MiB, WS_POOLED = 80 * MiB;
constexpr size_t WS_END = 229 * MiB;
constexpr int CW_BAR = 4096;

constexpr int RING_OFF = 0, RING_BYTES = 131072, EPI_OFF = 131072, EPI_BYTES = 12288, LDSCTL_OFF = EPI_OFF + EPI_BYTES, MISC_OFF = LDSCTL_OFF + 320;
constexpr int LDS_BYTES = 147456;
static_assert(MISC_OFF + 128 <= LDS_BYTES, "LDS map");

#define GAS __attribute__((address_space(1)))
#define LAS __attribute__((address_space(3)))
typedef unsigned short bf16;
typedef unsigned v4u __attribute__((ext_vector_type(4)));
typedef float f32x4 __attribute__((ext_vector_type(4)));
typedef GAS unsigned gu32;
#define RLX_AGENT __ATOMIC_RELAXED, __HIP_MEMORY_SCOPE_AGENT
#define LDS_WAIT() asm volatile("s_waitcnt lgkmcnt(0)" ::: "memory")
__device__ __forceinline__ unsigned f2bf(float f) { unsigned u = __builtin_bit_cast(unsigned, f); return (u + 0x7fffu + ((u >> 16) & 1u)) >> 16; }
__device__ __forceinline__ unsigned pk2(float lo, float hi) { return f2bf(lo) | (f2bf(hi) << 16); }
__device__ __forceinline__ float bf2f(unsigned short h) { return __builtin_bit_cast(float, (unsigned)h << 16); }

#define XB_TMO      128
#define XB_XCNT(j)  (256  + 64 * (j))
#define XB_XSUB(j)  (1280 + 64 * (j))
#define XB_XGEN(j)  (2304 + 64 * (j))
#define XB_TOP      3328
#define XB_TOPGEN   3392
#define XCD_BAR_WORDS 3456
#define XB_SPIN_CAP (1u << 18)
__device__ __forceinline__ unsigned xb_ld(unsigned* p)              { return __hip_atomic_load(p, __ATOMIC_RELAXED, __HIP_MEMORY_SCOPE_AGENT); }
__device__ __forceinline__ unsigned xb_add(unsigned* p, unsigned v) { return __hip_atomic_fetch_add(p, v, __ATOMIC_RELAXED, __HIP_MEMORY_SCOPE_AGENT); }
__device__ __forceinline__ unsigned xb_xcc_id() { return (unsigned)__builtin_amdgcn_s_getreg((3 << 11) | 20) & 0xFu; }
#define XB_SPIN(cond, bar) do { unsigned _sp = 0; while (cond) { __builtin_amdgcn_s_sleep(1); \
    if ((++_sp & 255u) == 0u) { if (xb_ld(&(bar)[XB_TMO])) break; if (_sp > XB_SPIN_CAP) { atomicAdd(&(bar)[XB_TMO], 1u); break; } } } } while (0)
struct XcdBarrier { unsigned* bar; unsigned x; volatile LAS unsigned* st; };
__device__ __forceinline__ XcdBarrier xcd_barrier_post(unsigned* bar, volatile LAS unsigned* st) {
    XcdBarrier b; b.bar = bar; b.x = xb_xcc_id(); b.st = st;
    if (threadIdx.x == 0) (void)xb_add(&bar[XB_XCNT(b.x)], 1u);
    return b;
}
__device__ __forceinline__ void xcd_barrier_complete(unsigned* bar, unsigned x, unsigned& nloc, unsigned& nx) {
    const unsigned G = gridDim.x * gridDim.y * gridDim.z;
    unsigned sum, cnt, mine, sp = 0u;
    for (;;) {
        sum = 0u; cnt = 0u; mine = 0u;
#pragma unroll
        for (unsigned j = 0; j < 16; ++j) { const unsigned c = xb_ld(&bar[XB_XCNT(j)]); sum += c; cnt += (c > 0u) ? 1u : 0u; mine = (j == x) ? c : mine; }
        if (sum == G) break;
        __builtin_amdgcn_s_sleep(1);
        if ((++sp & 255u) == 0u) { if (xb_ld(&bar[XB_TMO])) break; if (sp > XB_SPIN_CAP) { atomicAdd(&bar[XB_TMO], 1u); break; } }
    }
    nloc = mine > 0u ? mine : 1u; nx = cnt > 0u ? cnt : 1u;
}
__device__ __forceinline__ void xcd_barrier(const XcdBarrier& b) {
    asm volatile("s_waitcnt vmcnt(0)" ::: "memory");
    __syncthreads();
    if (threadIdx.x == 0) {
        unsigned* bar = b.bar;
        __builtin_amdgcn_s_waitcnt(0);
        unsigned nloc = b.st[0], nx = b.st[1];
        if (nloc == 0u) { xcd_barrier_complete(bar, b.x, nloc, nx); b.st[0] = nloc; b.st[1] = nx; }
        const unsigned old = xb_add(&bar[XB_XSUB(b.x)], 1u);
        const unsigned gen = old / nloc;
        if (old + 1u == (gen + 1u) * nloc) {
            __builtin_amdgcn_fence(__ATOMIC_RELEASE, "agent");
            asm volatile("s_waitcnt vmcnt(0)" ::: "memory");
            const unsigned og = xb_add(&bar[XB_TOP], 1u);
            const unsigned tg = og / nx;
            if (og + 1u == (tg + 1u) * nx) xb_add(&bar[XB_TOPGEN], 1u);
            else XB_SPIN(xb_ld(&bar[XB_TOPGEN]) == tg, bar);
            __builtin_amdgcn_fence(__ATOMIC_ACQUIRE, "agent");
            xb_add(&bar[XB_XGEN(b.x)], 1u);
            asm volatile("s_waitcnt vmcnt(0)" ::: "memory");
        } else {
            XB_SPIN(xb_ld(&bar[XB_XGEN(b.x)]) == gen, bar);
            __builtin_amdgcn_fence(__ATOMIC_ACQUIRE, "agent");
            asm volatile("s_waitcnt vmcnt(0)" ::: "memory");
        }
    }
    __syncthreads();
}

struct Args { const float* in[21]; float* out; unsigned char* ws; int ph_lo, ph_hi, li, pad; };
enum { I_X = 0, I_C, I_CTX, I_CCTX, I_WMOD, I_BMOD, I_GPREMIX, I_GPOSTMIX, I_GPREFFN, I_GPOSTFFN, I_WQKV, I_GQ, I_GK, I_WO, I_WPOOL, I_BPOOL, I_PSCALE, I_WUP, I_CONVW, I_CONVB, I_WDOWN };

__device__ __forceinline__ float wave_sum(float v) {
#pragma unroll
    for (int o = 1; o < 64; o <<= 1) v += __shfl_xor(v, o);
    return v;
}

template <class RowMap>
__device__ __forceinline__ void transpose_item(const float* W, int K, int N, bf16* WT, LAS float* scr, int item, int lane, RowMap rowmap) {
    const int nblk = N / 32, kb = item / nblk, nb = item % nblk, k0 = 64 * kb, n0 = 32 * nb;
#pragma unroll 8
    for (int i = 0; i < 32; ++i) { const int kk = 2 * i + (lane >> 5); scr[kk * 33 + (lane & 31)] = W[(size_t)(k0 + kk) * N + n0 + (lane & 31)]; }
    LDS_WAIT(); asm volatile("" ::: "memory");
    const int c = lane & 7;
#pragma unroll
    for (int j = 0; j < 4; ++j) { const int n = (lane >> 3) + 8 * j; const LAS float* s = scr + (8 * c) * 33 + n;
        v4u o; o.x = pk2(s[0 * 33], s[1 * 33]); o.y = pk2(s[2 * 33], s[3 * 33]); o.z = pk2(s[4 * 33], s[5 * 33]); o.w = pk2(s[6 * 33], s[7 * 33]);
        *(GAS v4u*)(WT + (size_t)rowmap(n0 + n) * K + k0 + 8 * c) = o; }
    LDS_WAIT(); asm volatile("" ::: "memory");
}
struct MapId { __device__ __forceinline__ int operator()(int n) const { return n; } };
struct MapQKV { __device__ __forceinline__ int operator()(int n) const {
    if (n >= 1280) return n; const int o = n & 127; const int wc = (((o >> 6) & 1) << 1) | ((o >> 4) & 1), nn = (o >> 5) & 1, fq = (o >> 2) & 3, j = o & 3; return (n & ~127) + 32 * wc + 8 * fq + 4 * nn + j; } };
struct MapUp { __device__ __forceinline__ int operator()(int n) const { return n < DFF ? (n >> 7) * 256 + (n & 127) : ((n - DFF) >> 7) * 256 + 128 + ((n - DFF) & 127); } };

template <bool NEXT>
__device__ __forceinline__ void row_update(const float* yrow, const float* xin, float* xout, const float* gate, const float* gpost,
                                           const float* gpre, const float* shift, const float* scale, bf16* hrow, int lane) {
    f32x4 y[4], x[4]; float s = 0.f;
#pragma unroll
    for (int j = 0; j < 4; ++j) { y[j] = ((const f32x4*)yrow)[lane + 64 * j]; s += (y[j].x * y[j].x + y[j].y * y[j].y) + (y[j].z * y[j].z + y[j].w * y[j].w); }
    const float rstd = 1.0f / sqrtf(wave_sum(s) * (1.0f / DM) + EPS); float s2 = 0.f;
#pragma unroll
    for (int j = 0; j < 4; ++j) { const f32x4 gt = ((const f32x4*)gate)[lane + 64 * j], gp = ((const f32x4*)gpost)[lane + 64 * j], xi = ((const f32x4*)xin)[lane + 64 * j];
        x[j] = xi + gt * (y[j] * rstd * gp); ((f32x4*)xout)[lane + 64 * j] = x[j];
        s2 += (x[j].x * x[j].x + x[j].y * x[j].y) + (x[j].z * x[j].z + x[j].w * x[j].w); }
    if (NEXT) {
        const float rstd2 = 1.0f / sqrtf(wave_sum(s2) * (1.0f / DM) + EPS);
#pragma unroll
        for (int j = 0; j < 4; ++j) { const f32x4 gp = ((const f32x4*)gpre)[lane + 64 * j], sh = ((const f32x4*)shift)[lane + 64 * j], sc = ((const f32x4*)scale)[lane + 64 * j];
            const f32x4 h = (x[j] * rstd2 * gp) * (sc + 1.0f) + sh;
            ((unsigned long long*)hrow)[lane + 64 * j] = (unsigned long long)pk2(h.x, h.y) | ((unsigned long long)pk2(h.z, h.w) << 32); }
    }
}
__device__ __forceinline__ void row_norm_mod(const float* xrow, const float* gpre, const float* shift, const float* scale, bf16* hrow, int lane) {
    f32x4 x[4]; float s = 0.f;
#pragma unroll
    for (int j = 0; j < 4; ++j) { x[j] = ((const f32x4*)xrow)[lane + 64 * j]; s += (x[j].x * x[j].x + x[j].y * x[j].y) + (x[j].z * x[j].z + x[j].w * x[j].w); }
    const float rstd = 1.0f / sqrtf(wave_sum(s) * (1.0f / DM) + EPS);
#pragma unroll
    for (int j = 0; j < 4; ++j) { const f32x4 gp = ((const f32x4*)gpre)[lane + 64 * j], sh = ((const f32x4*)shift)[lane + 64 * j], sc = ((const f32x4*)scale)[lane + 64 * j];
        const f32x4 h = (x[j] * rstd * gp) * (sc + 1.0f) + sh;
        ((unsigned long long*)hrow)[lane + 64 * j] = (unsigned long long)pk2(h.x, h.y) | ((unsigned long long)pk2(h.z, h.w) << 32); }
}

typedef const __attribute__((address_space(4))) Args* ArgsP;
__device__ __forceinline__ ArgsP get_args() { ArgsP p = (ArgsP)__builtin_amdgcn_kernarg_segment_ptr(); asm volatile("" : "+s"(p)); return p; }
__global__ void __launch_bounds__(NWAVES * 64, 2) trunk_fwd(Args args) {
    extern __shared__ __attribute__((aligned(16))) unsigned char lds[];
    LAS unsigned char* L = (LAS unsigned char*)lds;
    for (int u = threadIdx.x; u < (LDS_BYTES - LDSCTL_OFF) / 4; u += NWAVES * 64) ((LAS unsigned*)(L + LDSCTL_OFF))[u] = 0u;
    __syncthreads();
    if (N_LAUNCHES == 1) (void)xcd_barrier_post((unsigned*)((gu32*)(args.ws + WS_CTL) + CW_BAR), (volatile LAS unsigned*)(L + MISC_OFF) + 8);
#define GRID_BAR() do { if (N_LAUNCHES == 1) { XcdBarrier bar_; bar_.bar = (unsigned*)((gu32*)(get_args()->ws + WS_CTL) + CW_BAR); bar_.x = xb_xcc_id(); bar_.st = (volatile LAS unsigned*)(L + MISC_OFF) + 8; xcd_barrier(bar_); } } while (0)
#ifndef PHASE_MASK
#define PHASE_MASK 0x7fff
#endif
#define IN(k) (((PHASE_MASK >> (k)) & 1) && get_args()->ph_lo <= (k) && (k) < get_args()->ph_hi)
#define PH_ARGS ArgsP A = get_args(); unsigned char* ws = A->ws; (void)ws; \
    int tid = threadIdx.x; asm volatile("" : "+v"(tid)); const int lane = tid & 63, wave = __builtin_amdgcn_readfirstlane(tid >> 6); (void)lane; (void)wave; \
    const int G = gridDim.x, bx = blockIdx.x; const int vcu = (G % 8 == 0) ? (bx % 8) * (G / 8) + bx / 8 : bx; (void)vcu; \
    const int gw = vcu * NWAVES + wave, NGW = G * NWAVES; (void)gw; (void)NGW
#define x_in (A->in[I_X])
#define out (A->out)
#define MOD ((float*)(ws + WS_MOD))
#define COS ((float*)(ws + WS_COS))
#define SIN ((float*)(ws + WS_SIN))
#define Wqkv_t ((bf16*)(ws + WS_WQKV))
#define Wo_t ((bf16*)(ws + WS_WO))
#define Wpool_t ((bf16*)(ws + WS_WPOOL))
#define XN ((bf16*)(ws + WS_XN))
#define Qb ((bf16*)(ws + WS_Q))
#define Kb ((bf16*)(ws + WS_K))
#define Vb ((bf16*)(ws + WS_V))
#define Ob ((bf16*)(ws + WS_O))
#define ACT ((bf16*)(ws + WS_ACT))
#define XN2 ((bf16*)(ws + WS_XN2))
#define H1 ((bf16*)(ws + WS_H1))
#define POOLED ((bf16*)(ws + WS_POOLED))
#define Y ((float*)(ws + WS_Y))

    if (IN(0)) { PH_ARGS;
        for (int T = bx; T < 192; T += G) {
            const int l = T / 96, n0 = 64 * (T % 96);
            LAS float* sS = (LAS float*)(L + RING_OFF); LAS float* sP = (LAS float*)(L + RING_OFF + 36864);
            for (int idx = tid; idx < 9 * 1024; idx += 512) { const int r = idx >> 10, k = idx & 1023; const float v = r < 8 ? A->in[I_C][r * 1024 + k] : A->in[I_CCTX][k]; sS[idx] = v / (1.0f + __expf(-v)); }
            __syncthreads();
            { const int kq = tid >> 4, c4 = tid & 15; f32x4 a[9];
#pragma unroll
              for (int r = 0; r < 9; ++r) a[r] = (f32x4){0.f, 0.f, 0.f, 0.f};
              const float* wp = A->in[I_WMOD] + ((size_t)l * 1024 + kq * 32) * NMOD + n0 + 4 * c4;
              for (int kk = 0; kk < 32; ++kk) { const f32x4 w = *(const f32x4*)(wp + (size_t)kk * NMOD);
#pragma unroll
                  for (int r = 0; r < 9; ++r) a[r] += w * sS[r * 1024 + kq * 32 + kk]; }
#pragma unroll
              for (int r = 0; r < 9; ++r) *(LAS f32x4*)(sP + (kq * 9 + r) * 64 + 4 * c4) = a[r]; }
            __syncthreads();
            for (int o = tid; o < 576; o += 512) { const int r = o >> 6, cc = o & 63; float s = 0.f;
                for (int kq = 0; kq < 32; ++kq) s += sP[(kq * 9 + r) * 64 + cc];
                MOD[(size_t)(l * 9 + r) * NMOD + n0 + cc] = s + A->in[I_BMOD][l * NMOD + n0 + cc]; }
            __syncthreads();
        }
        if (bx == G - 1) for (int idx = tid; idx < 2048; idx += 512) { const int pos = idx >> 5, p = idx & 31;
            const float inv = exp2f(-(float)p * (13.287712379549449f / 32.0f)); const float ang = (float)pos * inv; COS[idx] = cosf(ang); SIN[idx] = sinf(ang); }
        LAS float* scr = (LAS float*)(L + RING_OFF + wave * 16384);
        constexpr int I_QKV = 16 * 48, I_O = 16 * 32, I_UP = 16 * 176, I_DN = 44 * 32, I_PL = 4 * 8;
        constexpr int NITEMS = I_QKV + I_O + 2 * I_UP + 2 * I_DN + 4 * I_PL;
        for (int it = gw; it < NITEMS; it += NGW) {
            int r = it;
            if (r < I_QKV) { transpose_item(A->in[I_WQKV], 1024, NQKV, Wqkv_t, scr, r, lane, MapQKV()); continue; } r -= I_QKV;
            if (r < I_O) { transpose_item(A->in[I_WO], 1024, 1024, Wo_t, scr, r, lane, MapId()); continue; } r -= I_O;
            if (r < 2 * I_UP) { const int l = r / I_UP; transpose_item(A->in[I_WUP] + (size_t)l * 1024 * NUP, 1024, NUP, (bf16*)(ws + (l ? WS_WUP1 : WS_WUP0)), scr, r % I_UP, lane, MapUp()); continue; } r -= 2 * I_UP;
            if (r < 2 * I_DN) { const int l = r / I_DN; transpose_item(A->in[I_WDOWN] + (size_t)l * DFF * 1024, DFF, 1024, (bf16*)(ws + (l ? WS_WDN1 : WS_WDN0)), scr, r % I_DN, lane, MapId()); continue; } r -= 2 * I_DN;
            { const int gi = r / I_PL; transpose_item(A->in[I_WPOOL] + (size_t)gi * 65536, 256, 256, Wpool_t + (size_t)gi * 65536, scr, r % I_PL, lane, MapId()); }
        }
        if (IN(1)) GRID_BAR();
    }

    if (IN(1)) { PH_ARGS;
        const float* gp = A->in[I_GPREMIX];
        for (int m = gw; m < MTOT; m += NGW) {
            const bool isc = m >= MLAT; const int r = isc ? 8 : (m >> 11);
            const float* xr = isc ? A->in[I_CTX] + (size_t)(m - MLAT) * DM : x_in + (size_t)m * DM;
            const float* md = MOD + (size_t)r * NMOD;
            row_norm_mod(xr, gp, md, md + DM, XN + (size_t)m * DM, lane);
        }
        if (IN(2)) GRID_BAR();
    }

    if (IN(2)) { PH_ARGS;
        pg8::Gemm g{XN, Wqkv_t, 1024, 1024, 256, 0, 0}; pg8::StaticOrder S; S.init(MTOT / 256, NQKV / 256, G, bx);
        pg8::EpiQKV E{Qb, Kb, Vb, A->in[I_GQ], A->in[I_GK], COS, SIN, (LAS float*)(L + EPI_OFF)};
        pg8::gemm_phase<pg8::EpiQKV, pg8::StaticOrder>(L + RING_OFF, g, S, E);
        if (IN(3)) GRID_BAR();
    }

    if (IN(3)) { PH_ARGS;
        for (int i = 0;; ++i) {
            const int Lx = i * G + vcu; if (Lx >= 512) break;
            int b, kvh, c;
            if (G == 256) { b = (Lx & 255) >> 5; kvh = Lx >> 8; c = Lx & 31; } else { b = Lx >> 6; kvh = (Lx >> 5) & 1; c = Lx & 31; }
            const int h = kvh * 4 + (c >> 3), qb = c & 7;
            att::attn_dense_body((const att::bf16*)Qb + ((size_t)(b * 8 + h) * 2048 + qb * 256) * 128,
                                 (const att::bf16*)Kb + (size_t)(b * 2 + kvh) * 2304 * 128, (const att::bf16*)Vb + (size_t)(b * 2 + kvh) * 2304 * 128,
                                 Ob + ((size_t)(b * 2048 + qb * 256)) * 1024 + h * 128, SKV, (char*)lds + RING_OFF);
        }
        if (IN(4)) GRID_BAR();
    }

    if (IN(4)) { PH_ARGS;
        pg8::Gemm g{Ob, Wo_t, 1024, 1024, 256, 0, 0}; pg8::StaticOrder S; S.init(MLAT / 256, 4, G, bx);
        pg8::EpiF32 E{Y, 1024, nullptr, nullptr};
        pg8::gemm_phase<pg8::EpiF32, pg8::StaticOrder>(L + RING_OFF, g, S, E);
        if (IN(5)) GRID_BAR();
    }

    if (IN(5)) { PH_ARGS;
        for (int m = gw; m < MLAT; m += NGW) { const float* md = MOD + (size_t)(m >> 11) * NMOD;
            row_update<true>(Y + (size_t)m * DM, x_in + (size_t)m * DM, out + (size_t)m * DM, md + 2 * DM, A->in[I_GPOSTMIX], A->in[I_GPREFFN], md + 3 * DM, md + 4 * DM, XN2 + (size_t)m * DM, lane); }
        if (IN(6)) GRID_BAR();
    }

#define FFN_PHASES(P_UP, P_DN, P_ROW, LYR, NEXTBLOCK)                                                                                               \
    if (IN(P_UP)) { PH_ARGS;                                                                                                                               \
        pg8::Gemm g{XN2, (const bf16*)(ws + ((LYR) ? WS_WUP1 : WS_WUP0)), 1024, 1024, 254, -1, 0}; pg8::StaticOrder S; S.init(65, NUP / 256, G, bx); \
        pg8::EpiGate E{ACT, A->in[I_CONVW] + (size_t)(LYR) * 3 * DFF, A->in[I_CONVB] + (size_t)(LYR) * DFF, (LAS float*)(L + EPI_OFF)};             \
        pg8::gemm_phase<pg8::EpiGate, pg8::StaticOrder>(L + RING_OFF, g, S, E);                                                                       \
        if (IN(P_DN)) GRID_BAR();                                                                                                                    \
    }                                                                                                                                                \
    if (IN(P_DN)) { PH_ARGS;                                                                                                                               \
        pg8::Gemm g{ACT, (const bf16*)(ws + ((LYR) ? WS_WDN1 : WS_WDN0)), DFF, DFF, 256, 0, 0}; pg8::StaticOrder S; S.init(MLAT / 256, 4, G, bx);    \
        pg8::EpiF32 E{Y, 1024, nullptr, nullptr};                                                                                                    \
        pg8::gemm_phase<pg8::EpiF32, pg8::StaticOrder>(L + RING_OFF, g, S, E);                                                                        \
        if (IN(P_ROW)) GRID_BAR();                                                                                                                   \
    }                                                                                                                                                \
    if (IN(P_ROW)) { PH_ARGS; NEXTBLOCK }

    FFN_PHASES(6, 7, 8, 0, {
        for (int m = gw; m < MLAT; m += NGW) { const float* md0 = MOD + (size_t)(m >> 11) * NMOD; const float* md1 = MOD + (size_t)(9 + (m >> 11)) * NMOD;
            row_update<true>(Y + (size_t)m * DM, out + (size_t)m * DM, out + (size_t)m * DM, md0 + 5 * DM, A->in[I_GPOSTFFN], A->in[I_GPREMIX] + DM, md1, md1 + DM, H1 + (size_t)m * DM, lane); }
        if (IN(9)) GRID_BAR();
    })

    if (IN(9)) { PH_ARGS;
        for (int gidx = bx * 512 + tid; gidx < 128 * 1024; gidx += G * 512) {
            const int c8 = gidx & 127, seg = gidx >> 7, t0 = seg * 16, sb = t0 & ~2047, se = sb + 2048;
            const int half = 1 << (c8 >> 5);
            const bf16* hp = H1 + c8 * 8;
            float sum[8];
#pragma unroll
            for (int e = 0; e < 8; ++e) sum[e] = 0.f;
            int wlo = t0 - half < sb ? sb : t0 - half, whi = t0 + half > se ? se : t0 + half;
            for (int t = wlo; t < whi; ++t) { const v4u v = *(const v4u*)(hp + (size_t)t * DM);
                sum[0] += bf2f(v.x & 0xffff); sum[1] += bf2f(v.x >> 16); sum[2] += bf2f(v.y & 0xffff); sum[3] += bf2f(v.y >> 16);
                sum[4] += bf2f(v.z & 0xffff); sum[5] += bf2f(v.z >> 16); sum[6] += bf2f(v.w & 0xffff); sum[7] += bf2f(v.w >> 16); }
            for (int t = t0; t < t0 + 16; ++t) {
                const int lo_t = t - half < sb ? sb : t - half, hi_t = t + half > se ? se : t + half;
                const float inv = 1.0f / (float)(hi_t - lo_t);
                const v4u v = *(const v4u*)(hp + (size_t)t * DM);
                float c[8] = {bf2f(v.x & 0xffff), bf2f(v.x >> 16), bf2f(v.y & 0xffff), bf2f(v.y >> 16), bf2f(v.z & 0xffff), bf2f(v.z >> 16), bf2f(v.w & 0xffff), bf2f(v.w >> 16)};
                v4u o; o.x = pk2(sum[0] * inv - c[0], sum[1] * inv - c[1]); o.y = pk2(sum[2] * inv - c[2], sum[3] * inv - c[3]);
                o.z = pk2(sum[4] * inv - c[4], sum[5] * inv - c[5]); o.w = pk2(sum[6] * inv - c[6], sum[7] * inv - c[7]);
                *(v4u*)(POOLED + (size_t)t * DM + c8 * 8) = o;
                if (t + half < se) { const v4u a = *(const v4u*)(hp + (size_t)(t + half) * DM);
                    sum[0] += bf2f(a.x & 0xffff); sum[1] += bf2f(a.x >> 16); sum[2] += bf2f(a.y & 0xffff); sum[3] += bf2f(a.y >> 16);
                    sum[4] += bf2f(a.z & 0xffff); sum[5] += bf2f(a.z >> 16); sum[6] += bf2f(a.w & 0xffff); sum[7] += bf2f(a.w >> 16); }
                if (t - half >= sb) { const v4u a = *(const v4u*)(hp + (size_t)(t - half) * DM);
                    sum[0] -= bf2f(a.x & 0xffff); sum[1] -= bf2f(a.x >> 16); sum[2] -= bf2f(a.y & 0xffff); sum[3] -= bf2f(a.y >> 16);
                    sum[4] -= bf2f(a.z & 0xffff); sum[5] -= bf2f(a.z >> 16); sum[6] -= bf2f(a.w & 0xffff); sum[7] -= bf2f(a.w >> 16); }
            }
        }
        if (IN(10)) GRID_BAR();
    }

    if (IN(10)) { PH_ARGS;
        pg8::Gemm g{POOLED, Wpool_t, 256, 1024, 256, 0, 512}; pg8::StaticOrder S; S.init(MLAT / 256, 4, G, bx);
        pg8::EpiF32 E{Y, 1024, A->in[I_BPOOL], A->in[I_PSCALE]};
        pg8::gemm_phase<pg8::EpiF32, pg8::StaticOrder>(L + RING_OFF, g, S, E);
        if (IN(11)) GRID_BAR();
    }

    if (IN(11)) { PH_ARGS;
        for (int m = gw; m < MLAT; m += NGW) { const float* md = MOD + (size_t)(9 + (m >> 11)) * NMOD;
            row_update<true>(Y + (size_t)m * DM, out + (size_t)m * DM, out + (size_t)m * DM, md + 2 * DM, A->in[I_GPOSTMIX] + DM, A->in[I_GPREFFN] + DM, md + 3 * DM, md + 4 * DM, XN2 + (size_t)m * DM, lane); }
        if (IN(12)) GRID_BAR();
    }

    FFN_PHASES(12, 13, 14, 1, {
        for (int m = gw; m < MLAT; m += NGW) { const float* md = MOD + (size_t)(9 + (m >> 11)) * NMOD;
            row_update<false>(Y + (size_t)m * DM, out + (size_t)m * DM, out + (size_t)m * DM, md + 5 * DM, A->in[I_GPOSTFFN] + DM, nullptr, nullptr, nullptr, nullptr, lane); }
    })
#undef IN
#undef GRID_BAR
}
#undef x_in
#undef out
#undef MOD
#undef COS
#undef SIN
#undef Wqkv_t
#undef Wo_t
#undef Wpool_t
#undef XN
#undef Qb
#undef Kb
#undef Vb
#undef Ob
#undef ACT
#undef XN2
#undef H1
#undef POOLED
#undef Y

extern "C" void kernel_launch(void* const* d_in, const int* in_sizes, int n_in, void* d_out, int out_size, void* d_ws, size_t ws_size, hipStream_t stream) {
    static int grid = 0;
    if (grid == 0) {
        if (n_in != 21 || in_sizes[0] != MLAT * DM || out_size != MLAT * DM || ws_size < WS_END) { fprintf(stderr, "kernel_launch: unexpected shapes (n_in %d, in0 %d, out %d, ws %zu)\n", n_in, n_in > 0 ? in_sizes[0] : -1, out_size, ws_size); grid = -1; return; }
        int dev = 0, cus = 0, per_cu = 0;
        if (hipGetDevice(&dev) != hipSuccess || hipDeviceGetAttribute(&cus, hipDeviceAttributeMultiprocessorCount, dev) != hipSuccess) { grid = -1; return; }
        if (hipFuncSetAttribute((const void*)trunk_fwd, hipFuncAttributeMaxDynamicSharedMemorySize, LDS_BYTES) != hipSuccess) { fprintf(stderr, "kernel_launch: hipFuncSetAttribute failed\n"); grid = -1; return; }
        if (hipOccupancyMaxActiveBlocksPerMultiprocessor(&per_cu, (const void*)trunk_fwd, NWAVES * 64, LDS_BYTES) != hipSuccess || per_cu < 1) { fprintf(stderr, "kernel_launch: occupancy query reports %d blocks per CU\n", per_cu); (void)hipGetLastError(); grid = -1; return; }
        grid = cus;
    }
    if (grid < 0) return;
    if (hipMemsetAsync((char*)d_ws + WS_CTL, 0, CTL_ZERO_BYTES, stream) != hipSuccess) return;
    Args a{};
    for (int i = 0; i < 21; ++i) a.in[i] = (const float*)d_in[i];
    a.out = (float*)d_out; a.ws = (unsigned char*)d_ws;
    for (int li = 0; li < N_LAUNCHES; ++li) {
        a.ph_lo = (N_LAUNCHES == 1) ? 0 : li; a.ph_hi = (N_LAUNCHES == 1) ? N_PHASES : li + 1; a.li = li;
        hipLaunchKernelGGL(trunk_fwd, dim3(grid), dim3(NWAVES * 64), LDS_BYTES, stream, a);
        const hipError_t le = hipPeekAtLastError();
        if (le != hipSuccess) { fprintf(stderr, "kernel_launch: launch %d failed: %s\n", li, hipGetErrorName(le)); break; }
    }
}
```
